# Optimizing an MI355X kernel written in HIP

```python
import jax, jax.numpy as jnp
from jax import lax
import numpy as np

D_MODEL = 1024
BATCH = 16
SEQ = 4096
DEPTH = 1
DEC_BATCH = 32
DEC_SEQ = 64
PAST_LEN = 1024

CHUNK = 64
SUB = 16
N_SUB = CHUNK // SUB
GLA_HEADS = 4
GLA_V = D_MODEL // 2
GLA_K = GLA_V // 2
GLA_DK = GLA_K // GLA_HEADS
GLA_DV = GLA_V // GLA_HEADS
GATE_RANK = 16
GATE_TAU = 16.0
HGRN_HEADS = 4
HGRN_W = D_MODEL - GLA_V
HGRN_D = HGRN_W // HGRN_HEADS
D_MIX = GLA_V + HGRN_W
IN_SPLITS = (GLA_K, GLA_K, GLA_V, GLA_V, GATE_RANK, HGRN_W, HGRN_W, HGRN_W, HGRN_W)
IN_COLS = sum(IN_SPLITS)
EPS = 1e-6

kernel_name = 'hymba_gla_hgrn2_stream_step'


def rms_norm(x, g):
    xf = x.astype(jnp.float32)
    y = xf * lax.rsqrt(jnp.mean(xf * xf, axis=-1, keepdims=True) + EPS)
    return (y * g.astype(jnp.float32)).astype(x.dtype)


def chunked_gla(q, k, v, g, s0):
    B, T, H, K = q.shape
    V = v.shape[-1]
    out_dtype = v.dtype
    pad = (-T) % CHUNK
    n = (T + pad) // CHUNK

    def to_chunks(a):
        a = jnp.pad(a.astype(jnp.float32), ((0, 0), (0, pad), (0, 0), (0, 0)))
        return a.reshape(B, n, CHUNK, H, a.shape[-1]).transpose(1, 0, 3, 2, 4)

    pos = jnp.arange(CHUNK)
    off_mask = pos[None, None, :] < (jnp.arange(N_SUB) * SUB)[:, None, None]
    diag_mask = jnp.tril(jnp.ones((SUB, SUB), dtype=bool))[:, :, None]

    def step(S, inp):
        qc, kc, vc, gc = inp
        b = jnp.cumsum(gc, axis=2)
        o_inter = jnp.einsum('bhck,bhkv->bhcv', qc * jnp.exp(b), S)
        qs = qc.reshape(B, H, N_SUB, SUB, K)
        ks = kc.reshape(B, H, N_SUB, SUB, K)
        vs = vc.reshape(B, H, N_SUB, SUB, V)
        bs = b.reshape(B, H, N_SUB, SUB, K)
        r = bs[:, :, :, 0] - gc.reshape(B, H, N_SUB, SUB, K)[:, :, :, 0]
        q_off = qs * jnp.exp(bs - r[:, :, :, None])
        k_off = kc[:, :, None] * jnp.exp(jnp.minimum(r[:, :, :, None] - b[:, :, None], 0.0))
        a_off = jnp.where(off_mask, jnp.einsum('bhnlk,bhnsk->bhnls', q_off, k_off), 0.0)
        diff = bs[:, :, :, :, None] - bs[:, :, :, None]
        decay = jnp.exp(jnp.where(diag_mask, diff, -jnp.inf))
        a_diag = jnp.einsum('bhntsk,bhnsk->bhnts', qs[:, :, :, :, None] * decay, ks)
        o_intra = (jnp.einsum('bhnls,bhsv->bhnlv', a_off, vc)
                   + jnp.einsum('bhnts,bhnsv->bhntv', a_diag, vs))
        b_last = b[:, :, -1]
        S_new = (S * jnp.exp(b_last)[..., None]
                 + jnp.einsum('bhck,bhcv->bhkv', kc * jnp.exp(b_last[:, :, None] - b), vc))
        return S_new, o_inter + o_intra.reshape(B, H, CHUNK, V)

    S, o = lax.scan(step, s0.astype(jnp.float32),
                    (to_chunks(q), to_chunks(k), to_chunks(v), to_chunks(g)))
    o = o.transpose(1, 0, 3, 2, 4).reshape(B, n * CHUNK, H, V)[:, :T]
    return o.astype(out_dtype), S


def mixer_layer(x, c, s_gla, s_hgrn, w_ada, b_ada, g_pre, w_in, w_alpha, b_alpha,
                g_on_gla, lb, g_on_hgrn, w_out, g_post):
    B, T, _ = x.shape
    mod = jnp.einsum('bd,de->be', c, w_ada) + b_ada
    shift, scale, gate = jnp.split(mod, 3, axis=-1)
    h = rms_norm(x, g_pre) * (1 + scale[:, None]) + shift[:, None]
    p = jnp.einsum('btd,de->bte', h, w_in)
    q_a, k_a, v_a, z_a, a_lr, q_h, f_h, i_h, z_h = jnp.split(
        p, np.cumsum(IN_SPLITS)[:-1].tolist(), axis=-1)

    log_alpha = jax.nn.log_sigmoid(
        (jnp.einsum('btr,rk->btk', a_lr, w_alpha) + b_alpha).astype(jnp.float32)) / GATE_TAU
    o_a, s_a = chunked_gla(
        q_a.reshape(B, T, GLA_HEADS, GLA_DK) * GLA_DK ** -0.5,
        k_a.reshape(B, T, GLA_HEADS, GLA_DK),
        v_a.reshape(B, T, GLA_HEADS, GLA_DV),
        log_alpha.reshape(B, T, GLA_HEADS, GLA_DK), s_gla)

    f = lb + (1.0 - lb) * jax.nn.sigmoid(f_h.astype(jnp.float32))
    o_h, s_h = chunked_gla(
        jax.nn.silu(q_h).reshape(B, T, HGRN_HEADS, HGRN_D),
        (1.0 - f).reshape(B, T, HGRN_HEADS, HGRN_D),
        i_h.reshape(B, T, HGRN_HEADS, HGRN_D),
        jnp.log(f).reshape(B, T, HGRN_HEADS, HGRN_D), s_hgrn)

    o_a = rms_norm(o_a, g_on_gla).reshape(B, T, GLA_V) * jax.nn.silu(z_a)
    o_h = rms_norm(o_h, g_on_hgrn).reshape(B, T, HGRN_W) * jax.nn.silu(z_h)
    o = jnp.einsum('bte,ed->btd', jnp.concatenate([o_a, o_h], axis=-1), w_out)
    y = x + gate[:, None] * rms_norm(o, g_post)
    return y, s_a, s_h


def setup_inputs(seed: int = 0) -> dict:
    key = jax.random.key(seed)
    ks = jax.random.split(key, 20)
    nrm = jax.random.normal
    f32 = jnp.float32
    return {
        'x_prompt': nrm(ks[0], (BATCH, SEQ, D_MODEL), f32),
        'x_sample': nrm(ks[1], (DEC_BATCH, DEC_SEQ, D_MODEL), f32),
        'c_prompt': nrm(ks[2], (BATCH, D_MODEL), f32),
        'c_sample': nrm(ks[3], (DEC_BATCH, D_MODEL), f32),
        'state_gla': 0.3 * nrm(ks[4], (DEPTH, DEC_BATCH, GLA_HEADS, GLA_DK, GLA_DV), f32),
        'state_hgrn': 0.3 * nrm(ks[5], (DEPTH, DEC_BATCH, HGRN_HEADS, HGRN_D, HGRN_D), f32),
        'w_ada': 0.5 * D_MODEL ** -0.5 * nrm(ks[6], (DEPTH, D_MODEL, 3 * D_MODEL), f32),
        'b_ada': 0.02 * nrm(ks[7], (DEPTH, 3 * D_MODEL), f32),
        'g_pre': 1.0 + 0.05 * nrm(ks[8], (DEPTH, D_MODEL), f32),
        'w_in': D_MODEL ** -0.5 * nrm(ks[9], (DEPTH, D_MODEL, IN_COLS), f32),
        'w_alpha': GATE_RANK ** -0.5 * nrm(ks[10], (DEPTH, GATE_RANK, GLA_K), f32),
        'b_alpha': 0.1 * nrm(ks[11], (DEPTH, GLA_K), f32),
        'g_onorm_gla': 1.0 + 0.05 * nrm(ks[12], (DEPTH, GLA_DV), f32),
        'hgrn_lb_logits': 0.3 * nrm(ks[13], (DEPTH + 1, HGRN_W), f32),
        'g_onorm_hgrn': 1.0 + 0.05 * nrm(ks[14], (DEPTH, HGRN_D), f32),
        'w_out': D_MIX ** -0.5 * nrm(ks[15], (DEPTH, D_MIX, D_MODEL), f32),
        'g_post': 1.0 + 0.05 * nrm(ks[16], (DEPTH, D_MODEL), f32),
    }


def reference(x_prompt, x_sample, c_prompt, c_sample, state_gla, state_hgrn, w_ada, b_ada, g_pre,
              w_in, w_alpha, b_alpha, g_onorm_gla, hgrn_lb_logits, g_onorm_hgrn, w_out, g_post):
    lower_bounds = jnp.cumsum(jax.nn.softmax(hgrn_lb_logits.astype(jnp.float32), axis=0), axis=0)
    bp = x_prompt.shape[0]
    zero_gla = jnp.zeros((bp, GLA_HEADS, GLA_DK, GLA_DV), jnp.float32)
    zero_hgrn = jnp.zeros((bp, HGRN_HEADS, HGRN_D, HGRN_D), jnp.float32)
    yp, ys = x_prompt, x_sample
    gla_p, hgrn_p, gla_s, hgrn_s = [], [], [], []
    for l in range(DEPTH):
        wl = (w_ada[l], b_ada[l], g_pre[l], w_in[l], w_alpha[l], b_alpha[l], g_onorm_gla[l],
              lower_bounds[l], g_onorm_hgrn[l], w_out[l], g_post[l])
        yp, sa, sh = mixer_layer(yp, c_prompt, zero_gla, zero_hgrn, *wl)
        gla_p.append(sa)
        hgrn_p.append(sh)
        ys, sa, sh = mixer_layer(ys, c_sample, state_gla[l], state_hgrn[l], *wl)
        gla_s.append(sa)
        hgrn_s.append(sh)
    new_gla_prompt = jnp.stack(gla_p).astype(x_prompt.dtype)
    new_hgrn_prompt = jnp.stack(hgrn_p).astype(x_prompt.dtype)
    new_gla_sample = jnp.stack(gla_s).astype(state_gla.dtype)
    new_hgrn_sample = jnp.stack(hgrn_s).astype(state_hgrn.dtype)
    return (yp, ys, new_gla_prompt, new_hgrn_prompt, new_gla_sample, new_hgrn_sample)
```

```cpp
#include <hip/hip_runtime.h>
#include <hip/hip_cooperative_groups.h>
#include <cstdio>
namespace cg = cooperative_groups;

#ifndef ONE_LAUNCH
#define ONE_LAUNCH 1
#endif
#ifndef NAIVE_P2
#define NAIVE_P2 0
#endif
#ifndef NAIVE_P3
#define NAIVE_P3 0
#endif
#ifndef NAIVE_P4
#define NAIVE_P4 0
#endif

#define LAS __attribute__((address_space(3)))
typedef unsigned short bf16_t;
typedef short bf16x8 __attribute__((ext_vector_type(8)));
typedef float f32x4 __attribute__((ext_vector_type(4)));
typedef float f32x2 __attribute__((ext_vector_type(2)));
typedef unsigned u32x4 __attribute__((ext_vector_type(4)));
typedef unsigned u32x2 __attribute__((ext_vector_type(2)));
typedef _Float16 h16x2 __attribute__((ext_vector_type(2)));

constexpr int DM = 1024;
constexpr int ROWS_P = 16 * 4096, ROWS_S = 32 * 64, MROWS = ROWS_P + ROWS_S;
constexpr int INC = 3600;
constexpr int N1 = 3840;
constexpr float EPS = 1e-6f;
constexpr int C_GQ = 0, C_GK = 256, C_GV = 512, C_GZ = 1024, C_GG = 1536, C_HQ = 1792, C_HG = 2304, C_HV = 2816, C_HZ = 3328;
constexpr size_t WS_WT1 = 0;
constexpr size_t WS_WT2 = 7864320;
constexpr size_t WS_MOD = 9961472;
constexpr size_t WS_SSQ = 10551296;
constexpr size_t WS_H = 16777216;
constexpr size_t WS_P = 167772160;
constexpr size_t WS_U = 721420288;
constexpr size_t WS_O = 905969664;
constexpr size_t WS_END = WS_O + (size_t)MROWS * 1024 * 2;
constexpr size_t OUT_YP = 0, OUT_YS = (size_t)ROWS_P * 1024, OUT_GP = OUT_YS + (size_t)ROWS_S * 1024, OUT_HP = OUT_GP + 16 * 4 * 64 * 128,
                 OUT_GS = OUT_HP + 16 * 4 * 128 * 128, OUT_HS = OUT_GS + 32 * 4 * 64 * 128;
constexpr int LDS_BYTES = 143360;

struct Params {
    const float *x_prompt, *x_sample, *c_prompt, *c_sample, *state_gla, *state_hgrn, *w_ada, *b_ada, *g_pre, *w_in, *w_alpha, *b_alpha,
        *g_on_gla, *lb_logits, *g_on_hgrn, *w_out, *g_post;
    float* out; unsigned char* ws;
    int ph_lo, ph_hi;
};

typedef __bf16 bf16x2_t __attribute__((ext_vector_type(2)));
__device__ __forceinline__ unsigned cvt_pk_bf16(float lo, float hi) { f32x2 f = {lo, hi}; bf16x2_t v = __builtin_convertvector(f, bf16x2_t); return __builtin_bit_cast(unsigned, v); }
__device__ __forceinline__ unsigned pk_f16(float a, float b) { h16x2 h; h.x = (_Float16)a; h.y = (_Float16)b; return __builtin_bit_cast(unsigned, h); }
__device__ __forceinline__ float bf_lo(unsigned u) { return __uint_as_float(u << 16); }
__device__ __forceinline__ float bf_hi(unsigned u) { return __uint_as_float(u & 0xffff0000u); }
__device__ __forceinline__ void unpack_bf4(u32x2 r, float (&f)[4]) { f[0] = bf_lo(r.x); f[1] = bf_hi(r.x); f[2] = bf_lo(r.y); f[3] = bf_hi(r.y); }
__device__ __forceinline__ h16x2 as_h2(unsigned u) { return __builtin_bit_cast(h16x2, u); }
__device__ __forceinline__ void unpack_h4(u32x2 r, float (&f)[4]) { const unsigned x = r[0], y = r[1]; const h16x2 a = as_h2(x), b = as_h2(y); f[0] = (float)a[0]; f[1] = (float)a[1]; f[2] = (float)b[0]; f[3] = (float)b[1]; }
__device__ __forceinline__ float fexp(float x) { return __builtin_amdgcn_exp2f(x * 1.44269504089f); }
__device__ __forceinline__ float flog(float x) { return __builtin_amdgcn_logf(x) * 0.69314718056f; }
__device__ __forceinline__ float fsilu(float x) { return x * __builtin_amdgcn_rcpf(1.0f + fexp(-x)); }

namespace pg8 {
constexpr int BM = 256, BK = 64, HALF = 128, HTB = HALF * BK * 2, STAGE_BYTES = 8 * HTB, NXCD = 8, WGM = 8;
__host__ __device__ __forceinline__ int lds_byte(int r, int c) { const int st = (r >> 4) * 2 + (c >> 5), rr = r & 15, cc = c & 31, ob = rr * 64 + cc * 2; return st * 1024 + (ob ^ (((ob >> 9) & 1) << 5)); }
__host__ __device__ __forceinline__ void stage_rc(int b, int& R, int& C) { const int st = b / 1024, sb = b % 1024, swz = sb ^ (((sb >> 9) & 1) << 5); R = (st >> 1) * 16 + swz / 64; C = (st & 1) * 32 + (swz % 64) / 2; }
__host__ __device__ __forceinline__ int perm32(int rho) { const int n = rho >> 4, i = rho & 15; return 8 * (i >> 2) + 4 * n + (i & 3); }
struct Unit { int pm, pn; };
struct Gemm { const bf16_t* A; const bf16_t* Bt; int M, N, K; };
struct StaticOrder {
    int nM, nN, nwg, G, c;
    __device__ void init(int M, int N, int G_, int c_) { nM = M / BM; nN = N / BM; nwg = nM * nN; G = G_; c = c_; }
    __device__ bool next(int i, Unit& u) const {
        const long L = (long)i * G + c; if (L >= nwg) return false;
        int wgid = (int)L; { const int q = nwg / NXCD, r = nwg % NXCD, xcd = wgid % NXCD, off = wgid / NXCD; wgid = (xcd < r ? xcd * (q + 1) : r * (q + 1) + (xcd - r) * q) + off; }
        const int nig = WGM * nN, gid = wgid / nig, fm = gid * WGM, gsz = (nM - fm) < WGM ? (nM - fm) : WGM;
        u.pm = fm + ((wgid % nig) % gsz); u.pn = (wgid % nig) / gsz; return true;
    }
};

template <class Epi>
__device__ __forceinline__ void gemm_phase(LAS unsigned char* lds, const Gemm g, const StaticOrder& S, const Epi& E) {
    const int tid = threadIdx.x, wid = __builtin_amdgcn_readfirstlane(tid >> 6), lane = tid & 63, wr = wid >> 2, wc = wid & 3, fr = lane & 15, fq = lane >> 4;
    const int K = g.K, nt = K / BK;
    unsigned voffA[2], voffB[2];
#pragma unroll
    for (int i = 0; i < 2; ++i) { int R, C; stage_rc(tid * 16 + i * 8192, R, C); const int Rb = Epi::PERM ? ((R & ~31) + perm32(R & 31)) : R;
        voffA[i] = (unsigned)(R * K + C) * 2u; voffB[i] = (unsigned)(Rb * K + C) * 2u; }
    const size_t kstep = (size_t)(BK * 2);
    const size_t hstep = (size_t)HALF * K * 2;
    const size_t tstep = 2 * hstep;
    const unsigned ldsw = (unsigned)wid * 1024u;
    const int aoff = lds_byte(wr * 64 + fr, fq * 8), boff = lds_byte(wc * 32 + fr, fq * 8);
#define PG8_SA(b, h) (((b) * 2 + (h)) * HTB)
#define PG8_SB(b, h) ((4 + (b) * 2 + (h)) * HTB)
#define PG8_STAGE(bufoff, gbase, voff) do { _Pragma("unroll") for (int _i = 0; _i < 2; ++_i) \
        __builtin_amdgcn_global_load_lds((const unsigned*)((const char*)(gbase) + (voff)[_i]), (LAS unsigned*)(lds + (bufoff) + ldsw + _i * 8192), 16, 0, 0); } while (0)
#define PG8_LDA(dst, b, h) do { _Pragma("unroll") for (int m = 0; m < 4; ++m) _Pragma("unroll") for (int k = 0; k < 2; ++k) dst[m][k] = *(const LAS bf16x8*)(lds + PG8_SA(b, h) + aoff + m * 2048 + k * 1024); } while (0)
#define PG8_LDB(dst, b, h) do { _Pragma("unroll") for (int n = 0; n < 2; ++n) _Pragma("unroll") for (int k = 0; k < 2; ++k) dst[n][k] = *(const LAS bf16x8*)(lds + PG8_SB(b, h) + boff + n * 2048 + k * 1024); } while (0)
#define PG8_MMA(ai, bj, At, Bt) do { __builtin_amdgcn_s_setprio(1); _Pragma("unroll") for (int m = 0; m < 4; ++m) _Pragma("unroll") for (int n = 0; n < 2; ++n) _Pragma("unroll") for (int k = 0; k < 2; ++k) \
        acc[ai][bj][m][n] = __builtin_amdgcn_mfma_f32_16x16x32_bf16(Bt[n][k], At[m][k], acc[ai][bj][m][n], 0, 0, 0); __builtin_amdgcn_s_setprio(0); } while (0)
#define PG8_WAIT_V(n) asm volatile("s_waitcnt vmcnt(" #n ")" ::: "memory")
#define PG8_WAIT_L(n) asm volatile("s_waitcnt lgkmcnt(" #n ")" ::: "memory")
#define PG8_BAR __builtin_amdgcn_s_barrier()
#define PG8_SCHED __builtin_amdgcn_sched_barrier(0)
    Unit cur, nxt; int ui = 0;
    if (!S.next(0, cur)) return;
    f32x4 acc[2][2][4][2];
#pragma unroll
    for (int a = 0; a < 2; ++a)
#pragma unroll
        for (int b = 0; b < 2; ++b)
#pragma unroll
            for (int m = 0; m < 4; ++m)
#pragma unroll
                for (int n = 0; n < 2; ++n) acc[a][b][m][n] = (f32x4){0.f, 0.f, 0.f, 0.f};
    bf16x8 At[4][2], B0[2][2], B1[2][2];
    const char* cA = (const char*)g.A + (size_t)cur.pm * tstep; const char* cB = (const char*)g.Bt + (size_t)cur.pn * tstep;
    PG8_STAGE(PG8_SB(0, 0), cB, voffB); PG8_STAGE(PG8_SA(0, 0), cA, voffA); PG8_STAGE(PG8_SB(0, 1), cB + hstep, voffB); PG8_STAGE(PG8_SA(0, 1), cA + hstep, voffA);
    if (wr == 1) PG8_BAR;
    PG8_WAIT_V(4); PG8_BAR;
    PG8_STAGE(PG8_SB(1, 0), cB + kstep, voffB); PG8_STAGE(PG8_SA(1, 0), cA + kstep, voffA); PG8_STAGE(PG8_SB(1, 1), cB + hstep + kstep, voffB);
    PG8_WAIT_V(6); PG8_BAR;
    for (;;) {
        const bool has_next = S.next(ui + 1, nxt);
        const char* nA = has_next ? (const char*)g.A + (size_t)nxt.pm * tstep : cA; const char* nB = has_next ? (const char*)g.Bt + (size_t)nxt.pn * tstep : cB;
        for (int t = 0; t < nt; t += 2) {
            const bool last = (t == nt - 2);
            const char* a1 = cA + (size_t)(t + 1) * kstep;
            const char* a2 = last ? nA : cA + (size_t)(t + 2) * kstep; const char* b2 = last ? nB : cB + (size_t)(t + 2) * kstep;
            const char* a3 = a2 + kstep; const char* b3 = b2 + kstep;
            PG8_LDB(B0, 0, 0); PG8_SCHED; PG8_LDA(At, 0, 0); PG8_STAGE(PG8_SA(1, 1), a1 + hstep, voffA);
            PG8_WAIT_L(8); PG8_BAR; PG8_WAIT_L(0); PG8_MMA(0, 0, At, B0); PG8_BAR; PG8_SCHED;
            PG8_LDB(B1, 0, 1); PG8_STAGE(PG8_SB(0, 0), b2, voffB);
            PG8_BAR; PG8_WAIT_L(0); PG8_MMA(0, 1, At, B1); PG8_BAR;
            PG8_LDA(At, 0, 1); PG8_STAGE(PG8_SA(0, 0), a2, voffA);
            PG8_BAR; PG8_WAIT_L(0); PG8_MMA(1, 0, At, B0); PG8_BAR; PG8_SCHED;
            PG8_STAGE(PG8_SB(0, 1), b2 + hstep, voffB);
            PG8_WAIT_V(6); PG8_BAR; PG8_MMA(1, 1, At, B1); PG8_BAR;
            PG8_LDB(B0, 1, 0); PG8_SCHED; PG8_LDA(At, 1, 0); PG8_STAGE(PG8_SA(0, 1), a2 + hstep, voffA);
            PG8_WAIT_L(8); PG8_BAR; PG8_WAIT_L(0); PG8_MMA(0, 0, At, B0); PG8_BAR; PG8_SCHED;
            PG8_LDB(B1, 1, 1); PG8_STAGE(PG8_SB(1, 0), b3, voffB);
            PG8_BAR; PG8_WAIT_L(0); PG8_MMA(0, 1, At, B1); PG8_BAR;
            PG8_LDA(At, 1, 1); PG8_STAGE(PG8_SA(1, 0), a3, voffA);
            PG8_BAR; PG8_WAIT_L(0); PG8_MMA(1, 0, At, B0); PG8_BAR; PG8_SCHED;
            PG8_STAGE(PG8_SB(1, 1), b3 + hstep, voffB);
            PG8_WAIT_V(6); PG8_BAR; PG8_MMA(1, 1, At, B1); PG8_BAR;
        }
        E(acc, cur, wr, wc, fr, fq);
        if (!has_next) break;
#pragma unroll
        for (int a = 0; a < 2; ++a)
#pragma unroll
            for (int b = 0; b < 2; ++b)
#pragma unroll
                for (int m = 0; m < 4; ++m)
#pragma unroll
                    for (int n = 0; n < 2; ++n) acc[a][b][m][n] = (f32x4){0.f, 0.f, 0.f, 0.f};
        cur = nxt; cA = nA; cB = nB; ++ui;
    }
    PG8_WAIT_V(0);
    if (wr == 0) PG8_BAR;
    PG8_BAR;
#undef PG8_SA
#undef PG8_SB
#undef PG8_STAGE
#undef PG8_LDA
#undef PG8_LDB
#undef PG8_MMA
#undef PG8_WAIT_V
#undef PG8_WAIT_L
#undef PG8_BAR
#undef PG8_SCHED
}
}

struct EpiP {
    static constexpr bool PERM = true;
    bf16_t* P; const float* b_alpha; const float* lbl;
    template <int MODE>
    __device__ __forceinline__ void run(const f32x4 (&acc)[2][2][4][2], const pg8::Unit& u, int wr, int wc, int fr, int fq) const {
        const int row0 = u.pm * 256 + wr * 64 + fr, col0 = u.pn * 256 + wc * 32 + 8 * fq;
        float prm[2][8];
#pragma unroll
        for (int bj = 0; bj < 2; ++bj)
#pragma unroll
            for (int e = 0; e < 8; ++e) {
                const int c = col0 + bj * 128 + e;
                if (MODE == 3) prm[bj][e] = b_alpha[c - C_GG];
                else if (MODE == 4) { const int j = c - C_HG; prm[bj][e] = 1.0f / (1.0f + fexp(lbl[512 + j] - lbl[j])); }
                else prm[bj][e] = 0.f;
            }
#pragma unroll
        for (int ai = 0; ai < 2; ++ai)
#pragma unroll
            for (int m = 0; m < 4; ++m) {
                bf16_t* rowp = P + (size_t)(row0 + ai * 128 + m * 16) * N1 + col0;
#pragma unroll
                for (int bj = 0; bj < 2; ++bj) {
                    float v[8];
#pragma unroll
                    for (int e = 0; e < 8; ++e) v[e] = acc[ai][bj][m][e >> 2][e & 3];
                    u32x4 w;
                    if (MODE == 0) { w.x = cvt_pk_bf16(v[0], v[1]); w.y = cvt_pk_bf16(v[2], v[3]); w.z = cvt_pk_bf16(v[4], v[5]); w.w = cvt_pk_bf16(v[6], v[7]); }
                    else if (MODE == 1) { w.x = cvt_pk_bf16(v[0] * 0.125f, v[1] * 0.125f); w.y = cvt_pk_bf16(v[2] * 0.125f, v[3] * 0.125f); w.z = cvt_pk_bf16(v[4] * 0.125f, v[5] * 0.125f); w.w = cvt_pk_bf16(v[6] * 0.125f, v[7] * 0.125f); }
                    else if (MODE == 2) {
#pragma unroll
                        for (int e = 0; e < 8; ++e) v[e] = fsilu(v[e]);
                        w.x = cvt_pk_bf16(v[0], v[1]); w.y = cvt_pk_bf16(v[2], v[3]); w.z = cvt_pk_bf16(v[4], v[5]); w.w = cvt_pk_bf16(v[6], v[7]);
                    } else if (MODE == 3) {
#pragma unroll
                        for (int e = 0; e < 8; ++e) { const float x = v[e] + prm[bj][e]; v[e] = (fminf(x, 0.f) - flog(1.0f + fexp(-fabsf(x)))) * 0.0625f; }
                        w.x = pk_f16(v[0], v[1]); w.y = pk_f16(v[2], v[3]); w.z = pk_f16(v[4], v[5]); w.w = pk_f16(v[6], v[7]);
                    } else {
#pragma unroll
                        for (int e = 0; e < 8; ++e) { const float s = __builtin_amdgcn_rcpf(1.0f + fexp(-v[e])); const float lb = prm[bj][e]; v[e] = flog(lb + (1.0f - lb) * s); }
                        w.x = pk_f16(v[0], v[1]); w.y = pk_f16(v[2], v[3]); w.z = pk_f16(v[4], v[5]); w.w = pk_f16(v[6], v[7]);
                    }
                    *(u32x4*)(rowp + bj * 128) = w;
                }
            }
    }
    __device__ __forceinline__ void operator()(const f32x4 (&acc)[2][2][4][2], const pg8::Unit& u, int wr, int wc, int fr, int fq) const {
        const int pn = u.pn;
        if (pn == 0) run<1>(acc, u, wr, wc, fr, fq);
        else if (pn == 6) run<3>(acc, u, wr, wc, fr, fq);
        else if (pn == 9 || pn == 10) run<4>(acc, u, wr, wc, fr, fq);
        else if (pn == 4 || pn == 5 || pn == 7 || pn == 8 || pn == 13 || pn == 14) run<2>(acc, u, wr, wc, fr, fq);
        else run<0>(acc, u, wr, wc, fr, fq);
    }
};
struct EpiU {
    static constexpr bool PERM = true;
    bf16_t* U; float* ssq;
    __device__ __forceinline__ void operator()(const f32x4 (&acc)[2][2][4][2], const pg8::Unit& u, int wr, int wc, int fr, int fq) const {
        const int row0 = u.pm * 256 + wr * 64 + fr, col0 = u.pn * 256 + wc * 32 + 8 * fq;
#pragma unroll
        for (int ai = 0; ai < 2; ++ai)
#pragma unroll
            for (int m = 0; m < 4; ++m) {
                const int row = row0 + ai * 128 + m * 16;
                bf16_t* rowp = U + (size_t)row * DM + col0;
                float s = 0.f;
#pragma unroll
                for (int bj = 0; bj < 2; ++bj) {
                    const f32x4 v0 = acc[ai][bj][m][0], v1 = acc[ai][bj][m][1];
                    s += (v0[0] * v0[0] + v0[1] * v0[1]) + (v0[2] * v0[2] + v0[3] * v0[3]);
                    s += (v1[0] * v1[0] + v1[1] * v1[1]) + (v1[2] * v1[2] + v1[3] * v1[3]);
                    u32x4 w; w.x = cvt_pk_bf16(v0[0], v0[1]); w.y = cvt_pk_bf16(v0[2], v0[3]); w.z = cvt_pk_bf16(v1[0], v1[1]); w.w = cvt_pk_bf16(v1[2], v1[3]);
                    *(u32x4*)(rowp + bj * 128) = w;
                }
                s += __shfl_xor(s, 16); s += __shfl_xor(s, 32);
                if (fq == 0) ssq[(size_t)row * 16 + u.pn * 4 + wc] = s;
            }
    }
};

__device__ __forceinline__ void p0_mod_unit(const Params& p, LAS unsigned char* lds, int u) {
    const int tid = threadIdx.x, w = __builtin_amdgcn_readfirstlane(tid >> 6), lane = tid & 63;
    const int e0 = u * 64;
    float acc[48];
#pragma unroll
    for (int b = 0; b < 48; ++b) acc[b] = 0.f;
    const float* wa = p.w_ada + (size_t)(128 * w) * 3072 + e0 + lane;
    for (int db = 0; db < 128; db += 16) {
        float wv[16];
#pragma unroll
        for (int i = 0; i < 16; ++i) wv[i] = wa[(size_t)(db + i) * 3072];
        const int dd = 128 * w + db;
#pragma unroll
        for (int b = 0; b < 48; ++b) {
            const float* cp = (b < 16) ? (p.c_prompt + b * 1024 + dd) : (p.c_sample + (b - 16) * 1024 + dd);
#pragma unroll
            for (int i = 0; i < 16; ++i) acc[b] += cp[i] * wv[i];
        }
    }
    LAS float* red = (LAS float*)lds;
#pragma unroll
    for (int b = 0; b < 48; ++b) red[(w * 48 + b) * 64 + lane] = acc[b];
    __syncthreads();
    float* mod = (float*)(p.ws + WS_MOD);
    for (int idx = tid; idx < 48 * 64; idx += 512) {
        const int b = idx >> 6, e = idx & 63;
        float s = 0.f;
#pragma unroll
        for (int ww = 0; ww < 8; ++ww) s += red[(ww * 48 + b) * 64 + e];
        const int col = e0 + e;
        s += p.b_ada[col];
        if (col >= 1024 && col < 2048) s = p.g_pre[col - 1024] * (1.0f + s);
        mod[b * 3072 + col] = s;
    }
}
__device__ __forceinline__ void p0_transpose_unit(const Params& p, LAS unsigned char* lds, int t) {
    const int tid = threadIdx.x;
    LAS float* tile = (LAS float*)lds;
    int nt, kt; const float* src; int ld, scol; bf16_t* dst; bool merged = false;
    if (t < 960) { nt = t % 60; kt = t / 60; src = p.w_in; ld = INC; dst = (bf16_t*)(p.ws + WS_WT1);
        const int n0 = nt * 64; if (n0 < 1536) scol = n0; else if (n0 < 1792) { scol = n0 - 1536; merged = true; } else scol = n0 - 240; }
    else { const int t2 = t - 960; nt = t2 % 16; kt = t2 / 16; src = p.w_out; ld = 1024; dst = (bf16_t*)(p.ws + WS_WT2); scol = nt * 64; }
    const int k0 = kt * 64;
    { const int kk = tid >> 4, n4 = (tid & 15) * 4;
#pragma unroll
      for (int i = 0; i < 2; ++i) {
          const int k = k0 + kk + 32 * i; f32x4 v;
          if (!merged) v = *(const f32x4*)(src + (size_t)k * ld + scol + n4);
          else { v = (f32x4){0.f, 0.f, 0.f, 0.f};
#pragma unroll
              for (int r4 = 0; r4 < 4; ++r4) { const f32x4 a = *(const f32x4*)(p.w_in + (size_t)k * INC + 1536 + r4 * 4);
#pragma unroll
                  for (int r = 0; r < 4; ++r) { const f32x4 wv = *(const f32x4*)(p.w_alpha + (r4 * 4 + r) * 256 + scol + n4); v += wv * a[r]; } } }
          LAS float* tp = tile + (kk + 32 * i) * 65 + n4; tp[0] = v[0]; tp[1] = v[1]; tp[2] = v[2]; tp[3] = v[3];
      } }
    __syncthreads();
    { const int n = tid >> 3, kq = (tid & 7) * 8; float f[8];
#pragma unroll
      for (int j = 0; j < 8; ++j) f[j] = tile[(kq + j) * 65 + n];
      u32x4 w; w.x = cvt_pk_bf16(f[0], f[1]); w.y = cvt_pk_bf16(f[2], f[3]); w.z = cvt_pk_bf16(f[4], f[5]); w.w = cvt_pk_bf16(f[6], f[7]);
      *(u32x4*)(dst + (size_t)(nt * 64 + n) * 1024 + k0 + kq) = w; }
}
__device__ __forceinline__ void phase0(const Params& p, LAS unsigned char* lds) {
    for (int u = blockIdx.x; u < 48 + 960 + 256; u += gridDim.x) {
        if (u < 48) p0_mod_unit(p, lds, u); else p0_transpose_unit(p, lds, u - 48);
        __syncthreads();
    }
}

__device__ __forceinline__ const float* xrow_ptr(const Params& p, int row) { return row < ROWS_P ? p.x_prompt + (size_t)row * DM : p.x_sample + (size_t)(row - ROWS_P) * DM; }
__device__ __forceinline__ int row_batch(int row) { return row < ROWS_P ? (row >> 12) : 16 + ((row - ROWS_P) >> 6); }
__device__ __forceinline__ void phase1(const Params& p) {
    const int w = threadIdx.x >> 6, lane = threadIdx.x & 63;
    const float* mod = (const float*)(p.ws + WS_MOD);
    bf16_t* H = (bf16_t*)(p.ws + WS_H);
    for (int row = blockIdx.x * 8 + w; row < MROWS; row += gridDim.x * 8) {
        const f32x4* xr = (const f32x4*)xrow_ptr(p, row);
        f32x4 v[4]; float s = 0.f;
#pragma unroll
        for (int i = 0; i < 4; ++i) { v[i] = xr[lane + 64 * i]; s += (v[i][0] * v[i][0] + v[i][1] * v[i][1]) + (v[i][2] * v[i][2] + v[i][3] * v[i][3]); }
#pragma unroll
        for (int o = 1; o < 64; o <<= 1) s += __shfl_xor(s, o);
        const float rinv = 1.0f / sqrtf(s * (1.0f / 1024.0f) + EPS);
        const float* mb = mod + row_batch(row) * 3072;
#pragma unroll
        for (int i = 0; i < 4; ++i) {
            const int c = 4 * (lane + 64 * i);
            const f32x4 sh = *(const f32x4*)(mb + c), gs = *(const f32x4*)(mb + 1024 + c);
            const f32x4 h = v[i] * rinv * gs + sh;
            u32x2 o; o.x = cvt_pk_bf16(h[0], h[1]); o.y = cvt_pk_bf16(h[2], h[3]);
            *(u32x2*)(H + (size_t)row * DM + c) = o;
        }
    }
}

__device__ __forceinline__ void phase5(const Params& p) {
    const int w = threadIdx.x >> 6, lane = threadIdx.x & 63;
    const float* mod = (const float*)(p.ws + WS_MOD);
    const bf16_t* U = (const bf16_t*)(p.ws + WS_U);
    const float* ssq = (const float*)(p.ws + WS_SSQ);
    for (int row = blockIdx.x * 8 + w; row < MROWS; row += gridDim.x * 8) {
        const f32x4* xr = (const f32x4*)xrow_ptr(p, row);
        f32x4* yr = (f32x4*)(p.out + (size_t)row * DM);
        const f32x4* sp = (const f32x4*)(ssq + (size_t)row * 16);
        const f32x4 s0 = sp[0], s1 = sp[1], s2 = sp[2], s3 = sp[3];
        const float tot = ((s0[0] + s0[1]) + (s0[2] + s0[3])) + ((s1[0] + s1[1]) + (s1[2] + s1[3])) + ((s2[0] + s2[1]) + (s2[2] + s2[3])) + ((s3[0] + s3[1]) + (s3[2] + s3[3]));
        const float rinv = 1.0f / sqrtf(tot * (1.0f / 1024.0f) + EPS);
        const float* gate = mod + row_batch(row) * 3072 + 2048;
#pragma unroll
        for (int i = 0; i < 4; ++i) {
            const int c = 4 * (lane + 64 * i);
            const f32x4 x = xr[lane + 64 * i];
            const u32x2 uu = *(const u32x2*)(U + (size_t)row * DM + c);
            float uf[4]; unpack_bf4(uu, uf);
            const f32x4 g = *(const f32x4*)(gate + c), gp = *(const f32x4*)(p.g_post + c);
            f32x4 y;
#pragma unroll
            for (int j = 0; j < 4; ++j) y[j] = x[j] + g[j] * (uf[j] * rinv * gp[j]);
            yr[lane + 64 * i] = y;
        }
    }
}

template <int K> struct ChainLds {
    static constexpr int STK = K * 2 + 16, STS = 144;
    static constexpr int QM = 0, QB = QM + 64 * STK, KM = QB + 64 * STK, KLT = KM + 64 * STK, VT = KLT + K * STS, AM = VT + 128 * STS, ST = AM + 64 * STS,
                         WT = ST + 128 * STK, ED = WT + 8 * K * 4, PART = ED + K * 4, END = PART + 64 * 8 * 4;
};
template <int K, bool HG>
__device__ __forceinline__ void chain_run(const Params& p, LAS unsigned char* lds, int row0, int nchunks, int colQ, int colK, int colG, int colV, int colZ, int ocol,
                                          const float* gon, const float* S0, float* Sout) {
    typedef ChainLds<K> L;
    static_assert(L::END <= LDS_BYTES, "LDS");
    constexpr int STK = L::STK, STS = L::STS, LPS = K / 4, NSEGW = 64 / LPS, RPS = LPS / 8, KS = K / 32, MT = K / 16;
    const int tid = threadIdx.x, w = __builtin_amdgcn_readfirstlane(tid >> 6), lane = tid & 63;
    int fr = lane & 15, fq = lane >> 4;
    int cq = tid % LPS, seg = tid / LPS, jseg = lane / LPS, lsub = lane % LPS;
    int cqv = tid & 31, segv = tid >> 5;
#define LAUNDER() asm volatile("" : "+v"(fr), "+v"(fq), "+v"(cq), "+v"(seg), "+v"(cqv), "+v"(segv), "+v"(lsub), "+v"(jseg))
    const bf16_t* P = (const bf16_t*)(p.ws + WS_P);
    bf16_t* O = (bf16_t*)(p.ws + WS_O);

    f32x4 accS[MT];
#pragma unroll
    for (int mt = 0; mt < MT; ++mt) {
#pragma unroll
        for (int j = 0; j < 4; ++j) accS[mt][j] = S0 ? S0[(size_t)(16 * mt + 4 * fq + j) * 128 + 16 * w + fr] : 0.f;
        u32x2 o; o.x = cvt_pk_bf16(accS[mt][0], accS[mt][1]); o.y = cvt_pk_bf16(accS[mt][2], accS[mt][3]);
        *(LAS u32x2*)(lds + L::ST + (16 * w + fr) * STK + (16 * mt + 4 * fq) * 2) = o;
    }
    const f32x4 gv = *(const f32x4*)(gon + 16 * w + 4 * fq);

    u32x2 qraw[RPS], kraw[RPS], graw[RPS], vraw[4];
    auto load_in = [&](int c) {
        const bf16_t* base = P + (size_t)(row0 + c * 64) * N1;
#pragma unroll
        for (int i = 0; i < RPS; ++i) {
            const bf16_t* rp = base + (size_t)(RPS * seg + i) * N1 + 4 * cq;
            qraw[i] = *(const u32x2*)(rp + colQ); graw[i] = *(const u32x2*)(rp + colG);
            if (!HG) kraw[i] = *(const u32x2*)(rp + colK);
        }
#pragma unroll
        for (int i = 0; i < 4; ++i) vraw[i] = *(const u32x2*)(base + (size_t)(4 * segv + i) * N1 + colV + 4 * cqv);
    };
    load_in(0);

    for (int c = 0; c < nchunks; ++c) {
        const int rowc = row0 + c * 64;
        LAUNDER();
        float gf[RPS][4], qf[RPS][4], kf[RPS][4];
#pragma unroll
        for (int i = 0; i < RPS; ++i) {
            unpack_h4(graw[i], gf[i]); unpack_bf4(qraw[i], qf[i]);
            if (HG) {
#pragma unroll
                for (int cc = 0; cc < 4; ++cc) kf[i][cc] = 1.0f - fexp(gf[i][cc]);
            } else unpack_bf4(kraw[i], kf[i]);
        }
        float bl[RPS][4], T[4];
#pragma unroll
        for (int cc = 0; cc < 4; ++cc) { float a = 0.f;
#pragma unroll
            for (int i = 0; i < RPS; ++i) { a += gf[i][cc]; bl[i][cc] = a; }
            T[cc] = a; }
        float pre[4] = {0.f, 0.f, 0.f, 0.f}, tot[4] = {0.f, 0.f, 0.f, 0.f};
#pragma unroll
        for (int jj = 0; jj < NSEGW; ++jj)
#pragma unroll
            for (int cc = 0; cc < 4; ++cc) { const float o = __shfl(T[cc], lsub + LPS * jj); tot[cc] += o; if (jj < jseg) pre[cc] += o; }
        if (jseg == 0) *(LAS f32x4*)(lds + L::WT + (w * K + 4 * cq) * 4) = (f32x4){tot[0], tot[1], tot[2], tot[3]};
        {
            float vf[4][4];
#pragma unroll
            for (int i = 0; i < 4; ++i) unpack_bf4(vraw[i], vf[i]);
#pragma unroll
            for (int cc = 0; cc < 4; ++cc) { u32x2 o; o.x = cvt_pk_bf16(vf[0][cc], vf[1][cc]); o.y = cvt_pk_bf16(vf[2][cc], vf[3][cc]);
                *(LAS u32x2*)(lds + L::VT + (4 * cqv + cc) * STS + (4 * segv) * 2) = o; }
        }
        __syncthreads();
        LAUNDER();
        f32x4 wpre = (f32x4){0.f, 0.f, 0.f, 0.f}, rmid = wpre, blast = wpre;
#pragma unroll
        for (int ww = 0; ww < 8; ++ww) { const f32x4 t = *(const LAS f32x4*)(lds + L::WT + (ww * K + 4 * cq) * 4);
            if (ww < w) wpre += t; if (ww < 4) rmid += t; blast += t; }
        float emid[4], elast[4];
#pragma unroll
        for (int cc = 0; cc < 4; ++cc) { emid[cc] = fexp(rmid[cc]); elast[cc] = fexp(blast[cc] - rmid[cc]); }
        if (seg == 0) *(LAS f32x4*)(lds + L::ED + (4 * cq) * 4) = (f32x4){fexp(blast[0]), fexp(blast[1]), fexp(blast[2]), fexp(blast[3])};
        float klv[RPS][4];
#pragma unroll
        for (int i = 0; i < RPS; ++i) {
            float qm[4], qb[4], km[4];
#pragma unroll
            for (int cc = 0; cc < 4; ++cc) {
                const float dm = (wpre[cc] + pre[cc] + bl[i][cc]) - rmid[cc];
                const float em = fexp(fminf(dm, 80.f)), ek = fexp(fminf(-dm, 80.f));
                qm[cc] = qf[i][cc] * em; qb[cc] = qm[cc] * emid[cc]; km[cc] = kf[i][cc] * ek; klv[i][cc] = km[cc] * elast[cc];
            }
            const int ro = (RPS * seg + i) * STK + (4 * cq) * 2;
            u32x2 o;
            o.x = cvt_pk_bf16(qm[0], qm[1]); o.y = cvt_pk_bf16(qm[2], qm[3]); *(LAS u32x2*)(lds + L::QM + ro) = o;
            o.x = cvt_pk_bf16(qb[0], qb[1]); o.y = cvt_pk_bf16(qb[2], qb[3]); *(LAS u32x2*)(lds + L::QB + ro) = o;
            o.x = cvt_pk_bf16(km[0], km[1]); o.y = cvt_pk_bf16(km[2], km[3]); *(LAS u32x2*)(lds + L::KM + ro) = o;
        }
#pragma unroll
        for (int cc = 0; cc < 4; ++cc) {
            if (RPS == 4) { u32x2 o; o.x = cvt_pk_bf16(klv[0][cc], klv[1][cc]); o.y = cvt_pk_bf16(klv[RPS - 2][cc], klv[RPS - 1][cc]);
                *(LAS u32x2*)(lds + L::KLT + (4 * cq + cc) * STS + (RPS * seg) * 2) = o; }
            else *(LAS unsigned*)(lds + L::KLT + (4 * cq + cc) * STS + (RPS * seg) * 2) = cvt_pk_bf16(klv[0][cc], klv[RPS - 1][cc]);
        }
        LAUNDER();
        if (c + 1 < nchunks) load_in(c + 1);
        u32x2 zraw[4];
#pragma unroll
        for (int n = 0; n < 4; ++n) zraw[n] = *(const u32x2*)(P + (size_t)(rowc + 16 * n + fr) * N1 + colZ + 16 * w + 4 * fq);
        __syncthreads();
        LAUNDER();
        {
            const int n = w & 3, mp = w >> 2;
            bf16x8 yq[KS];
#pragma unroll
            for (int ks = 0; ks < KS; ++ks) yq[ks] = *(const LAS bf16x8*)(lds + L::QM + (16 * n + fr) * STK + (32 * ks + 8 * fq) * 2);
#pragma unroll
            for (int mm = 0; mm < 2; ++mm) {
                const int m = 2 * mp + mm;
                f32x4 a = (f32x4){0.f, 0.f, 0.f, 0.f};
                if (m <= n) {
#pragma unroll
                    for (int ks = 0; ks < KS; ++ks) { const bf16x8 x = *(const LAS bf16x8*)(lds + L::KM + (16 * m + fr) * STK + (32 * ks + 8 * fq) * 2);
                        a = __builtin_amdgcn_mfma_f32_16x16x32_bf16(x, yq[ks], a, 0, 0, 0); }
#pragma unroll
                    for (int j = 0; j < 4; ++j) if (16 * m + 4 * fq + j > 16 * n + fr) a[j] = 0.f;
                }
                u32x2 o; o.x = cvt_pk_bf16(a[0], a[1]); o.y = cvt_pk_bf16(a[2], a[3]);
                *(LAS u32x2*)(lds + L::AM + (16 * n + fr) * STS + (16 * m + 4 * fq) * 2) = o;
            }
        }
        __syncthreads();
        LAUNDER();
        bf16x8 xs[KS], xv[2];
#pragma unroll
        for (int ks = 0; ks < KS; ++ks) xs[ks] = *(const LAS bf16x8*)(lds + L::ST + (16 * w + fr) * STK + (32 * ks + 8 * fq) * 2);
#pragma unroll
        for (int ks = 0; ks < 2; ++ks) xv[ks] = *(const LAS bf16x8*)(lds + L::VT + (16 * w + fr) * STS + (32 * ks + 8 * fq) * 2);
        f32x4 ao[4];
#pragma unroll
        for (int n = 0; n < 4; ++n) {
            ao[n] = (f32x4){0.f, 0.f, 0.f, 0.f};
#pragma unroll
            for (int ks = 0; ks < KS; ++ks) { const bf16x8 y = *(const LAS bf16x8*)(lds + L::QB + (16 * n + fr) * STK + (32 * ks + 8 * fq) * 2);
                ao[n] = __builtin_amdgcn_mfma_f32_16x16x32_bf16(xs[ks], y, ao[n], 0, 0, 0); }
#pragma unroll
            for (int ks = 0; ks < 2; ++ks) if (32 * ks <= 16 * n + 15) { const bf16x8 y = *(const LAS bf16x8*)(lds + L::AM + (16 * n + fr) * STS + (32 * ks + 8 * fq) * 2);
                ao[n] = __builtin_amdgcn_mfma_f32_16x16x32_bf16(xv[ks], y, ao[n], 0, 0, 0); }
            __builtin_amdgcn_sched_barrier(0);
        }
        LAUNDER();
#pragma unroll
        for (int mt = 0; mt < MT; ++mt) {
            const f32x4 ed = *(const LAS f32x4*)(lds + L::ED + (16 * mt + 4 * fq) * 4);
            accS[mt] = accS[mt] * ed;
#pragma unroll
            for (int ks = 0; ks < 2; ++ks) { const bf16x8 x = *(const LAS bf16x8*)(lds + L::KLT + (16 * mt + fr) * STS + (32 * ks + 8 * fq) * 2);
                accS[mt] = __builtin_amdgcn_mfma_f32_16x16x32_bf16(x, xv[ks], accS[mt], 0, 0, 0); }
            u32x2 o; o.x = cvt_pk_bf16(accS[mt][0], accS[mt][1]); o.y = cvt_pk_bf16(accS[mt][2], accS[mt][3]);
            *(LAS u32x2*)(lds + L::ST + (16 * w + fr) * STK + (16 * mt + 4 * fq) * 2) = o;
            __builtin_amdgcn_sched_barrier(0);
        }
#pragma unroll
        for (int n = 0; n < 4; ++n) {
            float s = (ao[n][0] * ao[n][0] + ao[n][1] * ao[n][1]) + (ao[n][2] * ao[n][2] + ao[n][3] * ao[n][3]);
            s += __shfl_xor(s, 16); s += __shfl_xor(s, 32);
            if (fq == 0) *(LAS float*)(lds + L::PART + ((16 * n + fr) * 8 + w) * 4) = s;
        }
        __syncthreads();
        LAUNDER();
#pragma unroll
        for (int n = 0; n < 4; ++n) {
            const f32x4 pa = *(const LAS f32x4*)(lds + L::PART + (16 * n + fr) * 32), pb = *(const LAS f32x4*)(lds + L::PART + (16 * n + fr) * 32 + 16);
            const float tot2 = ((pa[0] + pa[1]) + (pa[2] + pa[3])) + ((pb[0] + pb[1]) + (pb[2] + pb[3]));
            const float rinv = 1.0f / sqrtf(tot2 * (1.0f / 128.0f) + EPS);
            float zf[4]; unpack_bf4(zraw[n], zf);
            u32x2 o; o.x = cvt_pk_bf16(ao[n][0] * rinv * gv[0] * zf[0], ao[n][1] * rinv * gv[1] * zf[1]); o.y = cvt_pk_bf16(ao[n][2] * rinv * gv[2] * zf[2], ao[n][3] * rinv * gv[3] * zf[3]);
            *(u32x2*)(O + (size_t)(rowc + 16 * n + fr) * DM + ocol + 16 * w + 4 * fq) = o;
        }
    }
    LAUNDER();
#undef LAUNDER
#pragma unroll
    for (int mt = 0; mt < MT; ++mt)
#pragma unroll
        for (int j = 0; j < 4; ++j) Sout[(size_t)(16 * mt + 4 * fq + j) * 128 + 16 * w + fr] = accS[mt][j];
}
template <bool HGB>
__device__ __forceinline__ void phase3_pass(const Params& p, LAS unsigned char* lds) {
    const int G = gridDim.x, b = blockIdx.x;
    for (int r = 0; r * G < 384; ++r) {
        const int u = r * G + ((r & 1) ? (G - 1 - b) : b);
        if (u < 384 && !(NAIVE_P3 == 4 && u < 128)) {
            int row0, nchunks, bi, hh; const float* S0 = nullptr; float* Sout;
            if (u < 128) { bi = u >> 3; hh = u & 7; row0 = bi * 4096; nchunks = 64; }
            else { const int u2 = u - 128; bi = u2 >> 3; hh = u2 & 7; row0 = ROWS_P + bi * 64; nchunks = 1; }
            if (!HGB && hh < 4) {
                const int h = hh;
                if (u < 128) Sout = p.out + OUT_GP + (size_t)(bi * 4 + h) * 64 * 128;
                else { S0 = p.state_gla + (size_t)(bi * 4 + h) * 64 * 128; Sout = p.out + OUT_GS + (size_t)(bi * 4 + h) * 64 * 128; }
                chain_run<64, false>(p, lds, row0, nchunks, C_GQ + 64 * h, C_GK + 64 * h, C_GG + 64 * h, C_GV + 128 * h, C_GZ + 128 * h, 128 * h, p.g_on_gla, S0, Sout);
            }
            if (HGB && hh >= 4) {
                const int h = hh - 4;
                if (u < 128) Sout = p.out + OUT_HP + (size_t)(bi * 4 + h) * 128 * 128;
                else { S0 = p.state_hgrn + (size_t)(bi * 4 + h) * 128 * 128; Sout = p.out + OUT_HS + (size_t)(bi * 4 + h) * 128 * 128; }
                chain_run<128, true>(p, lds, row0, nchunks, C_HQ + 128 * h, 0, C_HG + 128 * h, C_HV + 128 * h, C_HZ + 128 * h, 512 + 128 * h, p.g_on_hgrn, S0, Sout);
            }
        }
        __syncthreads();
    }
}
__device__ __forceinline__ void phase3(const Params& p, LAS unsigned char* lds) {
#if NAIVE_P3 != 3
    phase3_pass<true>(p, lds);
#endif
#if NAIVE_P3 != 2
    phase3_pass<false>(p, lds);
#endif
}

__global__ void __launch_bounds__(512, 2) fwd_kernel(Params p) {
    extern __shared__ __attribute__((aligned(16))) unsigned char lds_raw[];
    LAS unsigned char* lds = (LAS unsigned char*)lds_raw;
    cg::grid_group grid = cg::this_grid();
    const int lo = p.ph_lo, hi = p.ph_hi;
#define IN(k) (lo <= (k) && (k) < hi)
#define SEAM(k) do { if (IN(k) && IN((k) + 1)) grid.sync(); } while (0)
    if (IN(0)) phase0(p, lds);
    SEAM(0);
    if (IN(1)) phase1(p);
    SEAM(1);
    if (IN(2)) {
        pg8::Gemm g{(const bf16_t*)(p.ws + WS_H), (const bf16_t*)(p.ws + WS_WT1), MROWS, N1, DM};
        pg8::StaticOrder S; S.init(MROWS, N1, (int)gridDim.x, (int)blockIdx.x);
        EpiP E{(bf16_t*)(p.ws + WS_P), p.b_alpha, p.lb_logits};
        pg8::gemm_phase<EpiP>(lds, g, S, E);
    }
    SEAM(2);
    if (IN(3)) phase3(p, lds);
    SEAM(3);
    if (IN(4)) {
        pg8::Gemm g{(const bf16_t*)(p.ws + WS_O), (const bf16_t*)(p.ws + WS_WT2), MROWS, DM, DM};
        pg8::StaticOrder S; S.init(MROWS, DM, (int)gridDim.x, (int)blockIdx.x);
        EpiU E{(bf16_t*)(p.ws + WS_U), (float*)(p.ws + WS_SSQ)};
        pg8::gemm_phase<EpiU>(lds, g, S, E);
    }
    SEAM(4);
    if (IN(5)) phase5(p);
#undef IN
#undef SEAM
}


__device__ __forceinline__ unsigned short bf16_1(float x) { return (unsigned short)(cvt_pk_bf16(x, 0.f) & 0xffffu); }
__device__ __forceinline__ float bf16_to_f(unsigned short h) { return __uint_as_float(((unsigned)h) << 16); }
__global__ void __launch_bounds__(256) naive_gemm(Params p, int which) {
    __shared__ float hs[128][64];
    __shared__ float alr[64][16];
    __shared__ float red[4][64];
    const int tid = threadIdx.x;
    const int ntn = which == 0 ? 15 : 4;
    const int pm = blockIdx.x / ntn, pn = blockIdx.x % ntn;
    const int r0 = pm * 64, n = pn * 256 + tid;
    const bf16_t* A = (const bf16_t*)(p.ws + (which == 0 ? WS_H : WS_O));
    const float* W; int ldw, wcol; int mode;
    if (which == 0) {
        W = p.w_in; ldw = INC;
        if (pn == 0) mode = 1; else if (pn == 6) mode = 5; else if (pn == 9 || pn == 10) mode = 4; else if (pn == 4 || pn == 5 || pn == 7 || pn == 8 || pn == 13 || pn == 14) mode = 2; else mode = 0;
        wcol = n < 1536 ? n : n - 240;
        if (mode == 5) wcol = 1536 + (tid & 15);
    } else { W = p.w_out; ldw = 1024; wcol = n; mode = 6; }
    float acc[64];
#pragma unroll
    for (int r = 0; r < 64; ++r) acc[r] = 0.f;
    for (int kc = 0; kc < 8; ++kc) {
        __syncthreads();
        for (int i = tid; i < 128 * 64; i += 256) { const int kk = i & 127, r = i >> 7; hs[kk][r] = bf16_to_f(A[(size_t)(r0 + r) * 1024 + kc * 128 + kk]); }
        __syncthreads();
        for (int kk = 0; kk < 128; ++kk) {
            const float wv = W[(size_t)(kc * 128 + kk) * ldw + wcol];
#pragma unroll
            for (int r = 0; r < 64; ++r) acc[r] += hs[kk][r] * wv;
        }
    }
    if (mode == 5) {
        __syncthreads();
        if (tid < 16) {
#pragma unroll
            for (int r = 0; r < 64; ++r) alr[r][tid] = acc[r]; }
        __syncthreads();
        const int j = n - C_GG;
#pragma unroll
        for (int r = 0; r < 64; ++r) { float s = 0.f; for (int q = 0; q < 16; ++q) s += alr[r][q] * p.w_alpha[q * 256 + j]; acc[r] = s; }
    }
    if (which == 0) {
        bf16_t* P = (bf16_t*)(p.ws + WS_P);
        float prm = 0.f;
        if (mode == 5) prm = p.b_alpha[n - C_GG];
        if (mode == 4) { const int j = n - C_HG; prm = 1.0f / (1.0f + expf(p.lb_logits[512 + j] - p.lb_logits[j])); }
#pragma unroll
        for (int r = 0; r < 64; ++r) {
            float x = acc[r]; unsigned short o;
            if (mode == 0) o = bf16_1(x);
            else if (mode == 1) o = bf16_1(x * 0.125f);
            else if (mode == 2) o = bf16_1(x / (1.0f + expf(-x)));
            else if (mode == 5) { x += prm; const float ls = fminf(x, 0.f) - log1pf(expf(-fabsf(x))); o = (unsigned short)(pk_f16(ls * 0.0625f, 0.f) & 0xffffu); }
            else { const float sg = 1.0f / (1.0f + expf(-x)); o = (unsigned short)(pk_f16(logf(prm + (1.0f - prm) * sg), 0.f) & 0xffffu); }
            P[(size_t)(r0 + r) * N1 + n] = o;
        }
    } else {
        bf16_t* U = (bf16_t*)(p.ws + WS_U); float* ssq = (float*)(p.ws + WS_SSQ);
        const int w = tid >> 6, lane = tid & 63;
#pragma unroll
        for (int r = 0; r < 64; ++r) {
            U[(size_t)(r0 + r) * 1024 + n] = bf16_1(acc[r]);
            float s = acc[r] * acc[r];
            for (int o = 1; o < 64; o <<= 1) s += __shfl_xor(s, o);
            if (lane == 0) red[w][r] = s;
        }
        __syncthreads();
        if (tid < 64) { const float s = (red[0][tid] + red[1][tid]) + (red[2][tid] + red[3][tid]);
            float* sp = ssq + (size_t)(r0 + tid) * 16 + pn * 4; sp[0] = s; sp[1] = 0.f; sp[2] = 0.f; sp[3] = 0.f; }
    }
}
template <int K, bool HG>
__device__ void naive_chain(const Params& p, int row0, int T, int colQ, int colK, int colG, int colV, int colZ, int ocol, const float* gon, const float* S0, float* Sout) {
    __shared__ float sq[128], sk[128], sd[128], sred[2];
    const int v = threadIdx.x;
    const bf16_t* P = (const bf16_t*)(p.ws + WS_P);
    bf16_t* O = (bf16_t*)(p.ws + WS_O);
    float S[K];
#pragma unroll
    for (int k = 0; k < K; ++k) S[k] = S0 ? S0[(size_t)k * 128 + v] : 0.f;
    for (int t = 0; t < T; ++t) {
        const bf16_t* rp = P + (size_t)(row0 + t) * N1;
        __syncthreads();
        if (v < K) {
            const float g = (float)__builtin_bit_cast(_Float16, rp[colG + v]);
            sq[v] = bf16_to_f(rp[colQ + v]); sd[v] = expf(g);
            sk[v] = HG ? (1.0f - expf(g)) : bf16_to_f(rp[colK + v]);
        }
        __syncthreads();
        const float vt = bf16_to_f(rp[colV + v]);
        float o = 0.f;
#pragma unroll
        for (int k = 0; k < K; ++k) { S[k] = sd[k] * S[k] + sk[k] * vt; o += sq[k] * S[k]; }
        float s = o * o;
        for (int off = 1; off < 64; off <<= 1) s += __shfl_xor(s, off);
        if ((v & 63) == 0) sred[v >> 6] = s;
        __syncthreads();
        const float rinv = 1.0f / sqrtf((sred[0] + sred[1]) * (1.0f / 128.0f) + EPS);
        const float z = bf16_to_f(rp[colZ + v]);
        O[(size_t)(row0 + t) * 1024 + ocol + v] = bf16_1(o * rinv * gon[v] * z);
    }
#pragma unroll
    for (int k = 0; k < K; ++k) Sout[(size_t)k * 128 + v] = S[k];
}
__global__ void __launch_bounds__(128) naive_rec(Params p, int sel) {
    const int u = blockIdx.x;
    if (sel == 1 && (u & 7) >= 4) return;
    if (sel == 2 && (u & 7) < 4) return;
    if (sel == 3 && u >= 128) return;
    int row0, T, bi, hh; const float* S0 = nullptr; float* Sout;
    if (u < 128) { bi = u >> 3; hh = u & 7; row0 = bi * 4096; T = 4096; }
    else { const int u2 = u - 128; bi = u2 >> 3; hh = u2 & 7; row0 = ROWS_P + bi * 64; T = 64; }
    if (hh < 4) { const int h = hh;
        if (u < 128) Sout = p.out + OUT_GP + (size_t)(bi * 4 + h) * 64 * 128;
        else { S0 = p.state_gla + (size_t)(bi * 4 + h) * 64 * 128; Sout = p.out + OUT_GS + (size_t)(bi * 4 + h) * 64 * 128; }
        naive_chain<64, false>(p, row0, T, C_GQ + 64 * h, C_GK + 64 * h, C_GG + 64 * h, C_GV + 128 * h, C_GZ + 128 * h, 128 * h, p.g_on_gla, S0, Sout);
    } else { const int h = hh - 4;
        if (u < 128) Sout = p.out + OUT_HP + (size_t)(bi * 4 + h) * 128 * 128;
        else { S0 = p.state_hgrn + (size_t)(bi * 4 + h) * 128 * 128; Sout = p.out + OUT_HS + (size_t)(bi * 4 + h) * 128 * 128; }
        naive_chain<128, true>(p, row0, T, C_HQ + 128 * h, 0, C_HG + 128 * h, C_HV + 128 * h, C_HZ + 128 * h, 512 + 128 * h, p.g_on_hgrn, S0, Sout);
    }
}

extern "C" void kernel_launch(void* const* d_in, const int* in_sizes, int n_in, void* d_out, int out_size, void* d_ws, size_t ws_size, hipStream_t stream) {
    static int grid = 0;
    if (grid == 0) {
        if (n_in != 17 || ws_size < WS_END) { fprintf(stderr, "kernel_launch: unexpected n_in %d / ws_size %zu (need %zu)\n", n_in, ws_size, (size_t)WS_END); grid = -1; return; }
        int dev = 0, cus = 0, per_cu = 0;
        hipGetDevice(&dev);
        hipDeviceGetAttribute(&cus, hipDeviceAttributeMultiprocessorCount, dev);
        if (hipFuncSetAttribute((const void*)fwd_kernel, hipFuncAttributeMaxDynamicSharedMemorySize, LDS_BYTES) != hipSuccess) { fprintf(stderr, "kernel_launch: hipFuncSetAttribute failed\n"); grid = -1; return; }
        if (hipOccupancyMaxActiveBlocksPerMultiprocessor(&per_cu, (const void*)fwd_kernel, 512, LDS_BYTES) != hipSuccess || per_cu < 1) { fprintf(stderr, "kernel_launch: occupancy query says %d\n", per_cu); per_cu = 1; }
        (void)hipGetLastError();
        grid = cus * 1;
        if (grid <= 0) grid = 256;
    }
    if (grid < 0) return;
    Params p{};
    p.x_prompt = (const float*)d_in[0]; p.x_sample = (const float*)d_in[1]; p.c_prompt = (const float*)d_in[2]; p.c_sample = (const float*)d_in[3];
    p.state_gla = (const float*)d_in[4]; p.state_hgrn = (const float*)d_in[5]; p.w_ada = (const float*)d_in[6]; p.b_ada = (const float*)d_in[7];
    p.g_pre = (const float*)d_in[8]; p.w_in = (const float*)d_in[9]; p.w_alpha = (const float*)d_in[10]; p.b_alpha = (const float*)d_in[11];
    p.g_on_gla = (const float*)d_in[12]; p.lb_logits = (const float*)d_in[13]; p.g_on_hgrn = (const float*)d_in[14]; p.w_out = (const float*)d_in[15];
    p.g_post = (const float*)d_in[16];
    p.out = (float*)d_out; p.ws = (unsigned char*)d_ws;
#if ONE_LAUNCH
    p.ph_lo = 0; p.ph_hi = 6;
    { void* args[] = {&p};
      hipError_t e = hipLaunchCooperativeKernel((const void*)fwd_kernel, dim3(grid), dim3(512), args, LDS_BYTES, stream);
      if (e != hipSuccess) fprintf(stderr, "kernel_launch: cooperative launch failed: %s (grid %d)\n", hipGetErrorString(e), grid); }
#else
    for (int ph = 0; ph < 6; ++ph) {
        if (ph == 2 && NAIVE_P2) { hipLaunchKernelGGL(naive_gemm, dim3(1056 * 15), dim3(256), 0, stream, p, 0); continue; }
        if (ph == 3 && NAIVE_P3 == 1) { hipLaunchKernelGGL(naive_rec, dim3(384), dim3(128), 0, stream, p, 0); continue; }
        if (ph == 3 && NAIVE_P3 >= 2) { hipLaunchKernelGGL(naive_rec, dim3(384), dim3(128), 0, stream, p, NAIVE_P3 - 1); }
        if (ph == 4 && NAIVE_P4) { hipLaunchKernelGGL(naive_gemm, dim3(1056 * 4), dim3(256), 0, stream, p, 1); continue; }
        p.ph_lo = ph; p.ph_hi = ph + 1;
        void* args[] = {&p};
        hipError_t e = hipLaunchCooperativeKernel((const void*)fwd_kernel, dim3(grid), dim3(512), args, LDS_BYTES, stream);
        if (e != hipSuccess) fprintf(stderr, "kernel_launch: launch %d failed: %s (grid %d)\n", ph, hipGetErrorString(e), grid);
    }
#endif
}
```
